# Optimizing an MI355X kernel written in HIP

```python
import math
import jax, jax.numpy as jnp
from jax import lax
import numpy as np

D_MODEL = 1024
BATCH = 16
SEQ = 2048
DEPTH = 1

HEAD_DIM = 64
SWA_Q_HEADS = 8
SWA_KV_HEADS = 2
SWA_WINDOW = 128
DIL_HEADS = 4
DIL_PAIRS = ((128, 1), (512, 4), (2048, 16))
MEM_HEADS = 4
MEM_LEN = 256

BLOCK = 128
ROPE_THETA = 10000.0
LN_EPS = 1e-5
RMS_EPS = 1e-6
DEEPNORM_ALPHA = (2 * DEPTH) ** 0.25
DEEPNORM_BETA = (8 * DEPTH) ** -0.25

W_A = SWA_Q_HEADS * HEAD_DIM
W_KV_A = SWA_KV_HEADS * HEAD_DIM
W_B = DIL_HEADS * HEAD_DIM
W_C = MEM_HEADS * HEAD_DIM
D_MIX = W_A + W_B + W_C
IN_SPLITS = (W_A, W_KV_A, W_KV_A, W_B, W_B, W_B, W_C, D_MIX)
D_IN = sum(IN_SPLITS)

kernel_name = "hymba_swa_sink_dilated_mem_deepnorm"


def rope_tables(seq_len):
    pos = jnp.arange(seq_len, dtype=jnp.float32)
    inv = ROPE_THETA ** (-jnp.arange(0, HEAD_DIM, 2, dtype=jnp.float32) / HEAD_DIM)
    ang = pos[:, None] * inv[None, :]
    ang = jnp.concatenate([ang, ang], axis=-1)
    return jnp.cos(ang), jnp.sin(ang)


def apply_rope(t, cos, sin):
    tf = t.astype(jnp.float32)
    half = HEAD_DIM // 2
    rot = jnp.concatenate([-tf[..., half:], tf[..., :half]], axis=-1)
    return (tf * cos[None, :, None, :] + rot * sin[None, :, None, :]).astype(t.dtype)


def banded_causal_attention(q, k, v, max_dist, sinks=None):
    N, L, H, D = q.shape
    Hkv = k.shape[2]
    G = H // Hkv
    n_blk = -(-L // BLOCK)
    pad = n_blk * BLOCK - L
    if pad:
        q, k, v = [jnp.pad(t, ((0, 0), (0, pad), (0, 0), (0, 0))) for t in (q, k, v)]
    qb = q.reshape(N, n_blk, BLOCK, Hkv, G, D)
    kb = k.reshape(N, n_blk, BLOCK, Hkv, D)
    vb = v.reshape(N, n_blk, BLOCK, Hkv, D)

    def with_prev(t):
        prev = jnp.pad(t, ((0, 0), (1, 0), (0, 0), (0, 0), (0, 0)))[:, :-1]
        return jnp.concatenate([prev, t], axis=2)

    kk, vv = with_prev(kb), with_prev(vb)
    s = jnp.einsum('nbqhgd,nbkhd->nbhgqk', qb, kk,
                   preferred_element_type=jnp.float32) * (D ** -0.5)
    qi = jnp.arange(BLOCK)[:, None]
    kj = jnp.arange(2 * BLOCK)[None, :]
    dist = qi + BLOCK - kj
    band = (dist >= 0) & (dist <= max_dist)
    blk = jnp.arange(n_blk)[:, None, None]
    mask = band[None] & ((blk > 0) | (kj >= BLOCK)[None])
    s = jnp.where(mask[None, :, None, None], s, -jnp.inf)
    m = s.max(axis=-1)
    if sinks is not None:
        sink = sinks.astype(jnp.float32).reshape(Hkv, G)[None, None, :, :, None]
        m = jnp.maximum(m, sink)
    p = jnp.exp(s - m[..., None])
    denom = p.sum(axis=-1)
    if sinks is not None:
        denom = denom + jnp.exp(sink - m)
    o = jnp.einsum('nbhgqk,nbkhd->nbqhgd', (p / denom[..., None]).astype(v.dtype), vv)
    lse = m + jnp.log(denom)
    o = o.reshape(N, n_blk * BLOCK, H, D)[:, :L]
    lse = lse.transpose(0, 1, 4, 2, 3).reshape(N, n_blk * BLOCK, H)[:, :L]
    return o, lse


def dilated_attention(q, k, v):
    B, S, H, D = q.shape
    outs, lses = [], []
    for window, dil in DIL_PAIRS:
        Ls = S // dil

        def to_stream(t):
            return t.reshape(B, Ls, dil, H, D).transpose(0, 2, 1, 3, 4).reshape(B * dil, Ls, H, D)

        o, lse = banded_causal_attention(to_stream(q), to_stream(k), to_stream(v), window // dil)
        outs.append(o.reshape(B, dil, Ls, H, D).transpose(0, 2, 1, 3, 4).reshape(B, S, H, D))
        lses.append(lse.reshape(B, dil, Ls, H).transpose(0, 2, 1, 3).reshape(B, S, H))
    w = jax.nn.softmax(jnp.stack(lses), axis=0)
    o = jnp.einsum('pbsh,pbshd->bshd', w, jnp.stack(outs).astype(jnp.float32))
    return o.astype(q.dtype)


def memory_attention(q, mk, mv):
    s = jnp.einsum('bshd,bmhd->bhsm', q, mk, preferred_element_type=jnp.float32) * (HEAD_DIM ** -0.5)
    p = jax.nn.softmax(s, axis=-1)
    return jnp.einsum('bhsm,bmhd->bshd', p.astype(mv.dtype), mv)


def rms_normalize(t):
    tf = t.astype(jnp.float32)
    return tf * lax.rsqrt(jnp.mean(tf * tf, axis=-1, keepdims=True) + RMS_EPS)


def layer_norm(t, gain, bias):
    tf = t.astype(jnp.float32)
    mu = jnp.mean(tf, axis=-1, keepdims=True)
    var = jnp.mean(jnp.square(tf - mu), axis=-1, keepdims=True)
    return (tf - mu) * lax.rsqrt(var + LN_EPS) * gain.astype(jnp.float32) + bias.astype(jnp.float32)


def setup_inputs(seed: int = 0) -> dict:
    key = jax.random.key(seed)
    ks = jax.random.split(key, 10)
    x = jax.random.normal(ks[0], (BATCH, SEQ, D_MODEL), jnp.float32)
    mem = jax.random.normal(ks[1], (BATCH, MEM_LEN, D_MODEL), jnp.float32)
    w_in = jax.random.normal(ks[2], (DEPTH, D_MODEL, D_IN), jnp.float32) * D_MODEL ** -0.5
    b_in = 0.02 * jax.random.normal(ks[3], (DEPTH, D_IN), jnp.float32)
    w_mem = jax.random.normal(ks[4], (DEPTH, D_MODEL, 2 * W_C), jnp.float32) * D_MODEL ** -0.5
    attn_sinks = 0.5 * jax.random.normal(ks[5], (DEPTH, SWA_Q_HEADS), jnp.float32)
    g_branch = 1.0 + 0.05 * jax.random.normal(ks[6], (DEPTH, D_MIX), jnp.float32)
    w_out = (jax.random.normal(ks[7], (DEPTH, D_MIX, D_MODEL), jnp.float32)
             * D_MIX ** -0.5 * DEEPNORM_BETA)
    ln_gain = 1.0 + 0.05 * jax.random.normal(ks[8], (DEPTH, D_MODEL), jnp.float32)
    ln_bias = 0.02 * jax.random.normal(ks[9], (DEPTH, D_MODEL), jnp.float32)
    return {"x": x, "mem": mem, "w_in": w_in, "b_in": b_in, "w_mem": w_mem,
            "attn_sinks": attn_sinks, "g_branch": g_branch, "w_out": w_out,
            "ln_gain": ln_gain, "ln_bias": ln_bias}


def reference(x, mem, w_in, b_in, w_mem, attn_sinks, g_branch, w_out, ln_gain, ln_bias):
    B, S, _ = x.shape
    M = mem.shape[1]
    cos, sin = rope_tables(S)
    split_idx = [int(i) for i in np.cumsum(IN_SPLITS)[:-1]]

    def heads(t, n):
        return t.reshape(t.shape[0], t.shape[1], n, HEAD_DIM)

    for l in range(DEPTH):
        h = jnp.einsum('bsd,de->bse', x, w_in[l]) + b_in[l]
        qa, ka, va, qb, kb, vb, qc, z = jnp.split(h, split_idx, axis=-1)

        oa, _ = banded_causal_attention(apply_rope(heads(qa, SWA_Q_HEADS), cos, sin),
                                        apply_rope(heads(ka, SWA_KV_HEADS), cos, sin),
                                        heads(va, SWA_KV_HEADS),
                                        SWA_WINDOW - 1, attn_sinks[l])
        ob = dilated_attention(apply_rope(heads(qb, DIL_HEADS), cos, sin),
                               apply_rope(heads(kb, DIL_HEADS), cos, sin),
                               heads(vb, DIL_HEADS))
        mkv = jnp.einsum('bmd,de->bme', mem, w_mem[l])
        mk, mv = jnp.split(mkv, 2, axis=-1)
        oc = memory_attention(heads(qc, MEM_HEADS), heads(mk, MEM_HEADS), heads(mv, MEM_HEADS))

        y = jnp.concatenate([rms_normalize(oa.reshape(B, S, W_A)),
                             rms_normalize(ob.reshape(B, S, W_B)),
                             rms_normalize(oc.reshape(B, S, W_C))], axis=-1)
        y = y * g_branch[l].astype(jnp.float32) * jax.nn.silu(z.astype(jnp.float32))
        y = jnp.einsum('bse,ed->bsd', y.astype(x.dtype), w_out[l])

        x = layer_norm(DEEPNORM_ALPHA * x + y, ln_gain[l], ln_bias[l]).astype(x.dtype)
    return x
```

```cpp
#include <hip/hip_runtime.h>
#include <hip/hip_cooperative_groups.h>
#include <cstdio>
#include <cstdint>
namespace cg = cooperative_groups;
namespace pg8 {
#define PG8_LAS __attribute__((address_space(3)))
typedef unsigned short bf16_t;
typedef short bf16x8 __attribute__((ext_vector_type(8)));
typedef float f32x4 __attribute__((ext_vector_type(4)));
typedef unsigned u32x4 __attribute__((ext_vector_type(4)));
constexpr int BM = 256, BK = 64, HALF = 128, HTB = HALF * BK * 2  , STAGE_BYTES = 8 * HTB, NXCD = 8, WGM = 8;

__host__ __device__ __forceinline__ int lds_byte(int r, int c) { const int st = (r >> 4) * 2 + (c >> 5), rr = r & 15, cc = c & 31, ob = rr * 64 + cc * 2; return st * 1024 + (ob ^ (((ob >> 9) & 1) << 5)); }
__host__ __device__ __forceinline__ void stage_rc(int b, int& R, int& C) { const int st = b / 1024, sb = b % 1024, swz = sb ^ (((sb >> 9) & 1) << 5); R = (st >> 1) * 16 + swz / 64; C = (st & 1) * 32 + (swz % 64) / 2; }
__host__ __device__ __forceinline__ int perm32(int rho) { const int n = rho >> 4, i = rho & 15; return 8 * (i >> 2) + 4 * n + (i & 3); }

struct Unit { int pm, pn; };
struct Gemm { const bf16_t* A; const bf16_t* Bt; int M, N, K; };

struct StaticOrder {
    int nM, nN, nwg, G, c;
    __host__ __device__ void init(int M, int N, int G_, int c_) { nM = M / BM; nN = N / BM; nwg = nM * nN; G = G_; c = c_; }
    __host__ __device__ bool next(int i, Unit& u) const {
        const long L = (long)i * G + c; if (L >= nwg) return false;
        int wgid = (int)L; { const int q = nwg / NXCD, r = nwg % NXCD, xcd = wgid % NXCD, off = wgid / NXCD; wgid = (xcd < r ? xcd * (q + 1) : r * (q + 1) + (xcd - r) * q) + off; }
        const int nig = WGM * nN, gid = wgid / nig, fm = gid * WGM, gsz = (nM - fm) < WGM ? (nM - fm) : WGM;
        u.pm = fm + ((wgid % nig) % gsz); u.pn = (wgid % nig) / gsz; return true;
    }
    __device__ __forceinline__ void a_ready(const Unit&) const {}
    __device__ __forceinline__ void done(const Unit&) const {}
};

__device__ __forceinline__ unsigned cvt_pk_bf16(float lo, float hi) { unsigned r; asm volatile("v_cvt_pk_bf16_f32 %0, %1, %2" : "=v"(r) : "v"(lo), "v"(hi)); return r; }
typedef float f32x2 __attribute__((ext_vector_type(2)));
__device__ __forceinline__ f32x2 gelu_pk(f32x2 v) {
    const f32x2 av = __builtin_elementwise_abs(v), d = av * 0.2316418882f + 1.0f;
    f32x2 t; t.x = __builtin_amdgcn_rcpf(d.x); t.y = __builtin_amdgcn_rcpf(d.y);
    f32x2 q = t * 0.5307027145f + (-0.7265760135f); q = q * t + 0.7107068705f; q = q * t + (-0.142248368f); q = q * t + 0.127414796f; q = q * t;
    const f32x2 s = (v * v) * (-0.72134752044f);
    f32x2 e; e.x = __builtin_amdgcn_exp2f(s.x); e.y = __builtin_amdgcn_exp2f(s.y);
    const f32x2 m = v * (q * e), r = v - m;
    f32x2 o; o.x = v.x < 0.f ? m.x : r.x; o.y = v.y < 0.f ? m.y : r.y; return o;
}

template <int ACT  > struct EpiBf16 {
    static constexpr bool PERM = true, AFTER_DRAIN = false; static_assert(ACT == 0 || ACT == 1, "EpiBf16: ACT is 0 (none) or 1 (gelu_pk)");
    bf16_t* O; int ldc; const float* bias; int split_cols; size_t split_stride; float scale0;
    __device__ __forceinline__ void operator()(const f32x4 (&acc)[2][2][4][2], const Unit& u, int wr, int wc, int fr, int fq) const {
        const int row0 = u.pm * BM + wr * 64 + fr; int colt = u.pn * BM; bf16_t* base = O;
        float sc = 1.f; if (split_cols) { const int t = colt / split_cols; base += (size_t)t * split_stride; colt -= t * split_cols; if (t == 0) sc = scale0; }
        const int col0 = colt + wc * 32 + 8 * fq, bcol0 = u.pn * BM + wc * 32 + 8 * fq;
        f32x4 bv[2][2];
#pragma unroll
        for (int bj = 0; bj < 2; ++bj)
#pragma unroll
            for (int n = 0; n < 2; ++n) bv[bj][n] = bias ? *(const f32x4*)(bias + bcol0 + bj * HALF + 4 * n) : (f32x4){0.f, 0.f, 0.f, 0.f};
#pragma unroll
        for (int ai = 0; ai < 2; ++ai)
#pragma unroll
            for (int m = 0; m < 4; ++m) { bf16_t* rowp = base + (size_t)(row0 + ai * HALF + m * 16) * ldc + col0;
#pragma unroll
                for (int bj = 0; bj < 2; ++bj) { f32x4 v0 = acc[ai][bj][m][0] + bv[bj][0], v1 = acc[ai][bj][m][1] + bv[bj][1];
                    if (ACT == 1) { f32x2 a = gelu_pk((f32x2){v0[0], v0[1]}), b = gelu_pk((f32x2){v0[2], v0[3]}), c = gelu_pk((f32x2){v1[0], v1[1]}), d = gelu_pk((f32x2){v1[2], v1[3]});
                        v0 = (f32x4){a.x, a.y, b.x, b.y}; v1 = (f32x4){c.x, c.y, d.x, d.y}; }
                    v0 = v0 * sc; v1 = v1 * sc; u32x4 w; w.x = cvt_pk_bf16(v0[0], v0[1]); w.y = cvt_pk_bf16(v0[2], v0[3]); w.z = cvt_pk_bf16(v1[0], v1[1]); w.w = cvt_pk_bf16(v1[2], v1[3]);
                    *(u32x4*)(rowp + bj * HALF) = w; } }
    }
};

struct PanelStats {
    unsigned* xbuf;
    unsigned* cnt;
    unsigned* tmo;
    int ntn; float eps;
    unsigned code;
    __device__ __forceinline__ bool run(const f32x4 (&v)[2][2][4][2], const Unit& u, int wr, int wc, int fr, int fq, PG8_LAS unsigned char* lds, int wid, int lane) const {
        typedef float f32x2v __attribute__((ext_vector_type(2)));
        PG8_LAS f32x2v* P = (PG8_LAS f32x2v*)lds;
        PG8_LAS f32x2v* S = (PG8_LAS f32x2v*)(lds + 8192);
        PG8_LAS unsigned* flag = (PG8_LAS unsigned*)(lds + 8192 + 2048);
#pragma unroll
        for (int ai = 0; ai < 2; ++ai)
#pragma unroll
            for (int m = 0; m < 4; ++m) {
                float s = 0.f;
#pragma unroll
                for (int bj = 0; bj < 2; ++bj)
#pragma unroll
                    for (int n = 0; n < 2; ++n) { const f32x4 x = v[ai][bj][m][n]; s += (x[0] + x[1]) + (x[2] + x[3]); }
                s += __shfl_xor(s, 16); s += __shfl_xor(s, 32);
                const float mw = s * (1.0f / 64.0f); float q = 0.f;
#pragma unroll
                for (int bj = 0; bj < 2; ++bj)
#pragma unroll
                    for (int n = 0; n < 2; ++n) { const f32x4 d = v[ai][bj][m][n] - mw; q += (d[0] * d[0] + d[1] * d[1]) + (d[2] * d[2] + d[3] * d[3]); }
                q += __shfl_xor(q, 16); q += __shfl_xor(q, 32);
                if (fq == 0) P[(ai * HALF + wr * 64 + m * 16 + fr) * 4 + wc] = (f32x2v){mw, q};
            }
        asm volatile("s_waitcnt lgkmcnt(0)" ::: "memory"); __builtin_amdgcn_s_barrier(); asm volatile("" ::: "memory");
#if defined(BROKEN_EXCHANGE_NO_WAIT)
#warning BROKEN CONTROL BUILD: the row-statistics exchange does not wait; results are wrong by design
        if (blockIdx.x >= 64) { const long long t0_ = clock64(); while (clock64() - t0_ < 60000) __builtin_amdgcn_s_sleep(8); }
#endif
        const int row = wid * 32 + (lane & 31);
        if (lane < 32) {
            const f32x2v a = P[row * 4 + 0], b = P[row * 4 + 1], c = P[row * 4 + 2], d = P[row * 4 + 3];
            const float mt = (a.x + b.x + c.x + d.x) * 0.25f;
            const float da = a.x - mt, db = b.x - mt, dc = c.x - mt, dd = d.x - mt;
            const float m2 = (a.y + b.y) + (c.y + d.y) + 64.0f * ((da * da + db * db) + (dc * dc + dd * dd));
            unsigned long long* slot = (unsigned long long*)xbuf + ((size_t)(u.pm * BM + row) * 4 + u.pn);
            __hip_atomic_store(slot, ((unsigned long long)__float_as_uint(m2) << 32) | __float_as_uint(mt), __ATOMIC_RELAXED, __HIP_MEMORY_SCOPE_AGENT);
        }
        asm volatile("s_waitcnt vmcnt(0)" ::: "memory");
        if (lane == 0) __hip_atomic_fetch_add(cnt + 64 * u.pm, 1u, __ATOMIC_RELAXED, __HIP_MEMORY_SCOPE_AGENT);
        if (wid == 0) {
            bool dead = false; const unsigned long long t0 = __builtin_amdgcn_s_memrealtime(); const unsigned want = 8u * (unsigned)ntn;
            for (;;) {
#if defined(BROKEN_EXCHANGE_NO_WAIT)
                break;
#endif
                if ((unsigned)__builtin_amdgcn_readfirstlane(__hip_atomic_load(cnt + 64 * u.pm, __ATOMIC_RELAXED, __HIP_MEMORY_SCOPE_AGENT)) >= want) break;
                if (__builtin_amdgcn_s_memrealtime() - t0 > 2000000ull) {
                    if (lane == 0) { unsigned expect = 0u; __hip_atomic_compare_exchange_strong(tmo + 1, &expect, code | (unsigned)(u.pm & 0xff), __ATOMIC_RELAXED, __ATOMIC_RELAXED, __HIP_MEMORY_SCOPE_AGENT);
                                     __hip_atomic_store(tmo, 1u, __ATOMIC_RELAXED, __HIP_MEMORY_SCOPE_AGENT); }
                    dead = true; break; }
                __builtin_amdgcn_s_sleep(2);
            }
            __builtin_amdgcn_fence(__ATOMIC_ACQUIRE, "agent");
            if (lane == 0) flag[0] = dead ? 1u : 0u;
        }
        asm volatile("s_waitcnt vmcnt(0) lgkmcnt(0)" ::: "memory"); __builtin_amdgcn_s_barrier(); asm volatile("" ::: "memory");
        const bool bad = flag[0] != 0u;
        if (lane < 32) {
            const unsigned long long* slot = (const unsigned long long*)xbuf + (size_t)(u.pm * BM + row) * 4; float mt[4], m2[4]; float ms = 0.f;
#pragma unroll
            for (int t = 0; t < 4; ++t) { if (t < ntn) { const unsigned long long w = __hip_atomic_load(slot + t, __ATOMIC_RELAXED, __HIP_MEMORY_SCOPE_AGENT); mt[t] = __uint_as_float((unsigned)w); m2[t] = __uint_as_float((unsigned)(w >> 32)); } else { mt[t] = 0.f; m2[t] = 0.f; } ms += mt[t]; }
            const float mean = ms / (float)ntn; float q = 0.f;
#pragma unroll
            for (int t = 0; t < 4; ++t) if (t < ntn) { const float dm = mt[t] - mean; q += m2[t] + 256.0f * dm * dm; }
            S[row] = (f32x2v){mean, 1.0f / sqrtf(q / (256.0f * (float)ntn) + eps)};
        }
        asm volatile("s_waitcnt lgkmcnt(0)" ::: "memory"); __builtin_amdgcn_s_barrier(); asm volatile("" ::: "memory");
        return bad;
    }
};
struct EpiLnRes {
    static constexpr bool PERM = false, AFTER_DRAIN = true;
    const float* base; float* out; int ldc; const float* bias; PanelStats st; unsigned poison;
    __device__ __forceinline__ void fused(f32x4 (&acc)[2][2][4][2], const Unit& u, int wr, int wc, int fr, int fq, PG8_LAS unsigned char* lds, int wid, int lane) const {
        typedef float f32x2v __attribute__((ext_vector_type(2)));
        const PG8_LAS f32x2v* S = (const PG8_LAS f32x2v*)(lds + 8192);
        const int col0 = u.pn * BM + wc * 32 + 4 * fq;
#pragma unroll
        for (int bj = 0; bj < 2; ++bj)
#pragma unroll
            for (int n = 0; n < 2; ++n) { const f32x4 bv = bias ? *(const f32x4*)(bias + col0 + bj * HALF + n * 16) : (f32x4){0.f, 0.f, 0.f, 0.f};
#pragma unroll
                for (int ai = 0; ai < 2; ++ai)
#pragma unroll
                    for (int m = 0; m < 4; ++m) acc[ai][bj][m][n] += bv; }
        f32x4 pre[4][2][2];
#pragma unroll
        for (int m = 0; m < 4; ++m) { const size_t off = (size_t)(u.pm * BM + wr * 64 + m * 16 + fr) * ldc + col0;
#pragma unroll
            for (int bj = 0; bj < 2; ++bj)
#pragma unroll
                for (int n = 0; n < 2; ++n) pre[m][bj][n] = *(const f32x4*)(base + off + bj * HALF + n * 16); }
        const bool bad = st.run(acc, u, wr, wc, fr, fq, lds, wid, lane) || poison != 0u;
        const float qnan = __builtin_nanf("");
#pragma unroll
        for (int ai = 0; ai < 2; ++ai)
#pragma unroll
            for (int m = 0; m < 4; ++m) { const int r = ai * HALF + wr * 64 + m * 16 + fr; const f32x2v sr = S[r]; const size_t off = (size_t)(u.pm * BM + r) * ldc + col0;
#pragma unroll
                for (int bj = 0; bj < 2; ++bj)
#pragma unroll
                    for (int n = 0; n < 2; ++n) { const f32x4 bs = ai == 0 ? pre[m][bj][n] : *(const f32x4*)(base + off + bj * HALF + n * 16); f32x4 o = bs + (acc[ai][bj][m][n] - sr.x) * sr.y;
                        if (bad) o = (f32x4){qnan, qnan, qnan, qnan}; *(f32x4*)(out + off + bj * HALF + n * 16) = o; }
                if (m & 1) asm volatile("" ::: "memory"); }
    }
};
struct EpiLnResLn {
    static constexpr bool PERM = false, AFTER_DRAIN = true;
    const float* base; float* out; bf16_t* xn; int ldc; const float* bias; PanelStats st1, st2; unsigned poison;
    __device__ __forceinline__ void fused(f32x4 (&acc)[2][2][4][2], const Unit& u, int wr, int wc, int fr, int fq, PG8_LAS unsigned char* lds, int wid, int lane) const {
        typedef float f32x2v __attribute__((ext_vector_type(2))); typedef unsigned u32x2v __attribute__((ext_vector_type(2)));
        const PG8_LAS f32x2v* S = (const PG8_LAS f32x2v*)(lds + 8192);
        const int col0 = u.pn * BM + wc * 32 + 4 * fq;
#pragma unroll
        for (int bj = 0; bj < 2; ++bj)
#pragma unroll
            for (int n = 0; n < 2; ++n) { const f32x4 bv = bias ? *(const f32x4*)(bias + col0 + bj * HALF + n * 16) : (f32x4){0.f, 0.f, 0.f, 0.f};
#pragma unroll
                for (int ai = 0; ai < 2; ++ai)
#pragma unroll
                    for (int m = 0; m < 4; ++m) acc[ai][bj][m][n] += bv; }
        bool bad = st1.run(acc, u, wr, wc, fr, fq, lds, wid, lane) || poison != 0u;
        const float qnan = __builtin_nanf("");
#pragma unroll
        for (int ai = 0; ai < 2; ++ai)
#pragma unroll
            for (int m = 0; m < 4; ++m) { const int r = ai * HALF + wr * 64 + m * 16 + fr; const f32x2v sr = S[r]; const size_t off = (size_t)(u.pm * BM + r) * ldc + col0;
#pragma unroll
                for (int bj = 0; bj < 2; ++bj)
#pragma unroll
                    for (int n = 0; n < 2; ++n) { const f32x4 bs = *(const f32x4*)(base + off + bj * HALF + n * 16); acc[ai][bj][m][n] = bs + (acc[ai][bj][m][n] - sr.x) * sr.y; }
                asm volatile("" : "+v"(acc[ai][0][m][0]), "+v"(acc[ai][0][m][1]), "+v"(acc[ai][1][m][0]), "+v"(acc[ai][1][m][1]));
                if (m & 1) asm volatile("" ::: "memory"); }
        const bool bad1 = bad;
        bad = st2.run(acc, u, wr, wc, fr, fq, lds, wid, lane) || bad;
#pragma unroll
        for (int ai = 0; ai < 2; ++ai)
#pragma unroll
            for (int m = 0; m < 4; ++m) { const int r = ai * HALF + wr * 64 + m * 16 + fr; const f32x2v sr = S[r]; const size_t off = (size_t)(u.pm * BM + r) * ldc + col0;
#pragma unroll
                for (int bj = 0; bj < 2; ++bj)
#pragma unroll
                    for (int n = 0; n < 2; ++n) { const f32x4 x1 = acc[ai][bj][m][n]; *(f32x4*)(out + off + bj * HALF + n * 16) = bad1 ? (f32x4){qnan, qnan, qnan, qnan} : x1;
                        const f32x4 o = (x1 - sr.x) * sr.y; u32x2v w; w.x = cvt_pk_bf16(o[0], o[1]); w.y = cvt_pk_bf16(o[2], o[3]);
                        if (bad) { w.x = 0x7fc07fc0u; w.y = 0x7fc07fc0u; } *(u32x2v*)(xn + off + bj * HALF + n * 16) = w; }
                asm volatile("" ::: "memory"); }
    }
};

template <class Epi, class Sched, bool ALIGN_EPI = false, bool SP2 = false>
__device__ __forceinline__ void gemm_phase(PG8_LAS unsigned char* lds, const Gemm g, const Sched& S, const Epi& E) {
    const int tid = threadIdx.x, wid = __builtin_amdgcn_readfirstlane(tid >> 6), lane = tid & 63, wr = wid >> 2, wc = wid & 3, fr = lane & 15, fq = lane >> 4;
    const int K = g.K, nt = K / BK;
    unsigned voffA[2], voffB[2];
#pragma unroll
    for (int i = 0; i < 2; ++i) { int R, C; stage_rc(tid * 16 + i * 8192, R, C); const int Rb = Epi::PERM ? ((R & ~31) + perm32(R & 31)) : R;
        voffA[i] = (unsigned)(R * K + C) * 2u; voffB[i] = (unsigned)(Rb * K + C) * 2u; }
    const size_t kstep = (size_t)(BK * 2);
    const size_t hstep = (size_t)HALF * K * 2;
    const size_t tstep = 2 * hstep;
    const unsigned ldsw = (unsigned)wid * 1024u;
    const int aoff = lds_byte(wr * 64 + fr, fq * 8), boff = lds_byte(wc * 32 + fr, fq * 8);
#define PG8_SA(b, h) (((b) * 2 + (h)) * HTB)
#define PG8_SB(b, h) ((4 + (b) * 2 + (h)) * HTB)
#define PG8_STAGE(bufoff, gbase, voff) do { _Pragma("unroll") for (int _i = 0; _i < 2; ++_i) \
        __builtin_amdgcn_global_load_lds((const unsigned*)((const char*)(gbase) + (voff)[_i]), (PG8_LAS unsigned*)(lds + (bufoff) + ldsw + _i * 8192), 16, 0, 0); } while (0)
#define PG8_LDA(dst, b, h) do { _Pragma("unroll") for (int m = 0; m < 4; ++m) _Pragma("unroll") for (int k = 0; k < 2; ++k) dst[m][k] = *(const PG8_LAS bf16x8*)(lds + PG8_SA(b, h) + aoff + m * 2048 + k * 1024); } while (0)
#define PG8_LDB(dst, b, h) do { _Pragma("unroll") for (int n = 0; n < 2; ++n) _Pragma("unroll") for (int k = 0; k < 2; ++k) dst[n][k] = *(const PG8_LAS bf16x8*)(lds + PG8_SB(b, h) + boff + n * 2048 + k * 1024); } while (0)
#define PG8_MMA(ai, bj, At, Bt) do { __builtin_amdgcn_s_setprio(1); _Pragma("unroll") for (int m = 0; m < 4; ++m) _Pragma("unroll") for (int n = 0; n < 2; ++n) _Pragma("unroll") for (int k = 0; k < 2; ++k) \
        acc[ai][bj][m][n] = __builtin_amdgcn_mfma_f32_16x16x32_bf16(Bt[n][k], At[m][k], acc[ai][bj][m][n], 0, 0, 0); __builtin_amdgcn_s_setprio(0); } while (0)
#define PG8_WAIT_V(n) asm volatile("s_waitcnt vmcnt(" #n ")" ::: "memory")
#define PG8_WAIT_L(n) asm volatile("s_waitcnt lgkmcnt(" #n ")" ::: "memory")
#define PG8_BAR __builtin_amdgcn_s_barrier()
#define PG8_SCHED __builtin_amdgcn_sched_barrier(0)
    Unit cur, nxt; int ui = 0;
    if (!S.next(0, cur)) return;
    f32x4 acc[2][2][4][2];
#pragma unroll
    for (int a = 0; a < 2; ++a)
#pragma unroll
        for (int b = 0; b < 2; ++b)
#pragma unroll
            for (int m = 0; m < 4; ++m)
#pragma unroll
                for (int n = 0; n < 2; ++n) acc[a][b][m][n] = (f32x4){0.f, 0.f, 0.f, 0.f};
    bf16x8 At[4][2], B0[2][2], B1[2][2];
    const char* cA = (const char*)g.A + (size_t)cur.pm * tstep; const char* cB = (const char*)g.Bt + (size_t)cur.pn * tstep;
    S.a_ready(cur);
    if constexpr (SP2) {
        PG8_STAGE(PG8_SB(0, 0), cB, voffB); PG8_STAGE(PG8_SB(0, 1), cB + hstep, voffB); PG8_STAGE(PG8_SA(0, 0), cA, voffA); PG8_STAGE(PG8_SA(0, 1), cA + hstep, voffA);
        if (wr == 1) PG8_BAR;
        PG8_WAIT_V(2); PG8_BAR;
        PG8_STAGE(PG8_SB(1, 0), cB + kstep, voffB); PG8_STAGE(PG8_SA(1, 0), cA + kstep, voffA); PG8_STAGE(PG8_SB(1, 1), cB + hstep + kstep, voffB);
        PG8_WAIT_V(6); PG8_BAR;
    } else {
        PG8_STAGE(PG8_SB(0, 0), cB, voffB); PG8_STAGE(PG8_SA(0, 0), cA, voffA); PG8_STAGE(PG8_SB(0, 1), cB + hstep, voffB); PG8_STAGE(PG8_SA(0, 1), cA + hstep, voffA);
        if (wr == 1) PG8_BAR;
        PG8_WAIT_V(4); PG8_BAR;
        PG8_STAGE(PG8_SB(1, 0), cB + kstep, voffB); PG8_STAGE(PG8_SA(1, 0), cA + kstep, voffA); PG8_STAGE(PG8_SB(1, 1), cB + hstep + kstep, voffB);
        PG8_WAIT_V(6); PG8_BAR;
    }
    for (;;) {
        const bool has_next = S.next(ui + 1, nxt);
        const char* nA = has_next ? (const char*)g.A + (size_t)nxt.pm * tstep : cA; const char* nB = has_next ? (const char*)g.Bt + (size_t)nxt.pn * tstep : cB;
        for (int t = 0; t < nt; t += 2) {
            const bool last = (t == nt - 2);
            const char* a1 = cA + (size_t)(t + 1) * kstep;
            const char* a2 = last ? nA : cA + (size_t)(t + 2) * kstep; const char* b2 = last ? nB : cB + (size_t)(t + 2) * kstep;
            const char* a3 = a2 + kstep; const char* b3 = b2 + kstep;
            if (last && has_next) S.a_ready(nxt);
            if constexpr (SP2) {
            PG8_LDB(B0, 0, 0); PG8_LDB(B1, 0, 1); PG8_SCHED; PG8_LDA(At, 0, 0); PG8_STAGE(PG8_SA(1, 1), a1 + hstep, voffA);
            PG8_WAIT_V(8); PG8_WAIT_L(0); PG8_BAR; PG8_MMA(0, 0, At, B0); PG8_MMA(0, 1, At, B1); PG8_BAR; PG8_SCHED;
            PG8_LDA(At, 0, 1); PG8_STAGE(PG8_SB(0, 0), b2, voffB); PG8_STAGE(PG8_SB(0, 1), b2 + hstep, voffB); PG8_STAGE(PG8_SA(0, 0), a2, voffA);
            PG8_WAIT_V(8); PG8_WAIT_L(0); PG8_BAR; PG8_MMA(1, 0, At, B0); PG8_MMA(1, 1, At, B1); PG8_BAR; PG8_SCHED;
            PG8_LDB(B0, 1, 0); PG8_LDB(B1, 1, 1); PG8_SCHED; PG8_LDA(At, 1, 0); PG8_STAGE(PG8_SA(0, 1), a2 + hstep, voffA);
            PG8_WAIT_V(8); PG8_WAIT_L(0); PG8_BAR; PG8_MMA(0, 0, At, B0); PG8_MMA(0, 1, At, B1); PG8_BAR; PG8_SCHED;
            PG8_LDA(At, 1, 1); PG8_STAGE(PG8_SB(1, 0), b3, voffB); PG8_STAGE(PG8_SB(1, 1), b3 + hstep, voffB); PG8_STAGE(PG8_SA(1, 0), a3, voffA);
            PG8_WAIT_V(8); PG8_WAIT_L(0); PG8_BAR; PG8_MMA(1, 0, At, B0); PG8_MMA(1, 1, At, B1); PG8_BAR; PG8_SCHED;
            } else {
            PG8_LDB(B0, 0, 0); PG8_SCHED; PG8_LDA(At, 0, 0); PG8_STAGE(PG8_SA(1, 1), a1 + hstep, voffA);
            PG8_WAIT_L(8); PG8_BAR; PG8_WAIT_L(0); PG8_MMA(0, 0, At, B0); PG8_BAR; PG8_SCHED;
            PG8_LDB(B1, 0, 1); PG8_STAGE(PG8_SB(0, 0), b2, voffB);
            PG8_BAR; PG8_WAIT_L(0); PG8_MMA(0, 1, At, B1); PG8_BAR;
            PG8_LDA(At, 0, 1); PG8_STAGE(PG8_SA(0, 0), a2, voffA);
            PG8_BAR; PG8_WAIT_L(0); PG8_MMA(1, 0, At, B0); PG8_BAR; PG8_SCHED;
            PG8_STAGE(PG8_SB(0, 1), b2 + hstep, voffB);
            PG8_WAIT_V(6); PG8_BAR; PG8_MMA(1, 1, At, B1); PG8_BAR;
            PG8_LDB(B0, 1, 0); PG8_SCHED; PG8_LDA(At, 1, 0); PG8_STAGE(PG8_SA(0, 1), a2 + hstep, voffA);
            PG8_WAIT_L(8); PG8_BAR; PG8_WAIT_L(0); PG8_MMA(0, 0, At, B0); PG8_BAR; PG8_SCHED;
            PG8_LDB(B1, 1, 1); PG8_STAGE(PG8_SB(1, 0), b3, voffB);
            PG8_BAR; PG8_WAIT_L(0); PG8_MMA(0, 1, At, B1); PG8_BAR;
            PG8_LDA(At, 1, 1); PG8_STAGE(PG8_SA(1, 0), a3, voffA);
            PG8_BAR; PG8_WAIT_L(0); PG8_MMA(1, 0, At, B0); PG8_BAR; PG8_SCHED;
            PG8_STAGE(PG8_SB(1, 1), b3 + hstep, voffB);
            PG8_WAIT_V(6); PG8_BAR; PG8_MMA(1, 1, At, B1); PG8_BAR;
            }
        }
        if constexpr (ALIGN_EPI) { if (wr == 0) PG8_BAR; }
        if constexpr (!Epi::AFTER_DRAIN) { E(acc, cur, wr, wc, fr, fq); S.done(cur); }
        if (!has_next) break;
#pragma unroll
        for (int a = 0; a < 2; ++a)
#pragma unroll
            for (int b = 0; b < 2; ++b)
#pragma unroll
                for (int m = 0; m < 4; ++m)
#pragma unroll
                    for (int n = 0; n < 2; ++n) acc[a][b][m][n] = (f32x4){0.f, 0.f, 0.f, 0.f};
        cur = nxt; cA = nA; cB = nB; ++ui;
        if constexpr (ALIGN_EPI) { if (wr == 1) PG8_BAR; }
    }
    PG8_WAIT_V(0);
    if constexpr (!ALIGN_EPI) { if (wr == 0) PG8_BAR; }
    PG8_BAR;
    if constexpr (Epi::AFTER_DRAIN) { E.fused(acc, cur, wr, wc, fr, fq, lds, wid, lane); S.done(cur); }
#undef PG8_SA
#undef PG8_SB
#undef PG8_STAGE
#undef PG8_LDA
#undef PG8_LDB
#undef PG8_MMA
#undef PG8_WAIT_V
#undef PG8_WAIT_L
#undef PG8_BAR
#undef PG8_SCHED
}
}

#ifndef N_LAUNCHES
#define N_LAUNCHES 6
#endif
constexpr int NPHASE = 6;
constexpr int BATCH = 16, SEQ = 2048, DM = 1024, NTOK = BATCH * SEQ;
constexpr int DIN = 2816, MEML = 256, NMEM = BATCH * MEML;
constexpr int WMEM = 512, DMIX = 1024;
constexpr float QSCALE = 0.125f * 1.4426950408889634f;
constexpr float LOG2E = 1.4426950408889634f;
constexpr float DN_ALPHA = 1.189207115002721f;
constexpr float LN_EPS = 1e-5f, RMS_EPS = 1e-6f;

typedef unsigned short bf16;
typedef unsigned u32x4 __attribute__((ext_vector_type(4)));
typedef unsigned u32x2 __attribute__((ext_vector_type(2)));
typedef float f32x4 __attribute__((ext_vector_type(4)));
typedef short bf16x8 __attribute__((ext_vector_type(8)));
typedef short s16x4 __attribute__((ext_vector_type(4)));
typedef float f32x16 __attribute__((ext_vector_type(16)));
#define LAS __attribute__((address_space(3)))

constexpr size_t MiB = 1u << 20;
constexpr size_t WS_WIN = 0, WS_WOUT = 6 * MiB, WS_WMEM = 8 * MiB, WS_COS = 9 * MiB, WS_SIN = 9 * MiB + 256 * 1024;
constexpr size_t WS_MEMB = 10 * MiB, WS_MKV = 18 * MiB, WS_LSE = 22 * MiB, WS_XB = 32 * MiB, WS_H = 96 * MiB;
constexpr size_t WS_OA = 272 * MiB, WS_OB = 304 * MiB, WS_OC = 352 * MiB, WS_Y = 368 * MiB, WS_END = 432 * MiB;

struct Args {
    const float *x, *mem, *w_in, *b_in, *w_mem, *sinks, *g_branch, *w_out, *ln_g, *ln_b;
    float* out; unsigned char* ws; int ph_lo, ph_hi;
};

__device__ __forceinline__ unsigned f2bf(float f) { unsigned u = __builtin_bit_cast(unsigned, f); return (u + 0x7fffu + ((u >> 16) & 1u)) >> 16; }
__device__ __forceinline__ unsigned pk2(float lo, float hi) { return f2bf(lo) | (f2bf(hi) << 16); }
__device__ __forceinline__ float bf_lo(unsigned w) { return __builtin_bit_cast(float, w << 16); }
__device__ __forceinline__ float bf_hi(unsigned w) { return __builtin_bit_cast(float, w & 0xffff0000u); }

struct EpiIn {
    static constexpr bool PERM = true, AFTER_DRAIN = false;
    bf16* H; const float* bias; const float* cosT; const float* sinT;
    __device__ __forceinline__ void operator()(const pg8::f32x4 (&acc)[2][2][4][2], const pg8::Unit& u, int wr, int wc, int fr, int fq) const {
        const int head = u.pn * 4 + wc;
        const bool rope = (head < 10) || (head >= 12 && head < 20);
        const bool scl = (head < 8) || (head >= 12 && head < 16) || (head >= 24 && head < 28);
        const float sc = scl ? QSCALE : 1.f;
        const int clo = head * 64 + 8 * fq, chi = clo + 32;
        f32x4 blo[2], bhi[2];
#pragma unroll
        for (int n = 0; n < 2; ++n) { blo[n] = *(const f32x4*)(bias + clo + 4 * n); bhi[n] = *(const f32x4*)(bias + chi + 4 * n); }
#pragma unroll
        for (int ai = 0; ai < 2; ++ai)
#pragma unroll
            for (int m = 0; m < 4; ++m) {
                const int row = u.pm * 256 + ai * 128 + wr * 64 + m * 16 + fr;
                f32x4 lo0 = acc[ai][0][m][0] + blo[0], lo1 = acc[ai][0][m][1] + blo[1], hi0 = acc[ai][1][m][0] + bhi[0], hi1 = acc[ai][1][m][1] + bhi[1];
                if (rope) {
                    const int pos = row & (SEQ - 1);
                    const f32x4 c0 = *(const f32x4*)(cosT + pos * 32 + 8 * fq), c1 = *(const f32x4*)(cosT + pos * 32 + 8 * fq + 4);
                    const f32x4 s0 = *(const f32x4*)(sinT + pos * 32 + 8 * fq), s1 = *(const f32x4*)(sinT + pos * 32 + 8 * fq + 4);
                    const f32x4 nl0 = lo0 * c0 - hi0 * s0, nl1 = lo1 * c1 - hi1 * s1, nh0 = hi0 * c0 + lo0 * s0, nh1 = hi1 * c1 + lo1 * s1;
                    lo0 = nl0; lo1 = nl1; hi0 = nh0; hi1 = nh1;
                }
                lo0 = lo0 * sc; lo1 = lo1 * sc; hi0 = hi0 * sc; hi1 = hi1 * sc;
                u32x4 wl, wh;
                wl.x = pg8::cvt_pk_bf16(lo0[0], lo0[1]); wl.y = pg8::cvt_pk_bf16(lo0[2], lo0[3]); wl.z = pg8::cvt_pk_bf16(lo1[0], lo1[1]); wl.w = pg8::cvt_pk_bf16(lo1[2], lo1[3]);
                wh.x = pg8::cvt_pk_bf16(hi0[0], hi0[1]); wh.y = pg8::cvt_pk_bf16(hi0[2], hi0[3]); wh.z = pg8::cvt_pk_bf16(hi1[0], hi1[1]); wh.w = pg8::cvt_pk_bf16(hi1[2], hi1[3]);
                bf16* rp = H + (size_t)row * DIN;
                *(u32x4*)(rp + clo) = wl; *(u32x4*)(rp + chi) = wh;
            }
    }
};
struct EpiOut {
    static constexpr bool PERM = true, AFTER_DRAIN = false;
    const float* x; float* out;
    __device__ __forceinline__ void operator()(const pg8::f32x4 (&acc)[2][2][4][2], const pg8::Unit& u, int wr, int wc, int fr, int fq) const {
#pragma unroll
        for (int ai = 0; ai < 2; ++ai)
#pragma unroll
            for (int m = 0; m < 4; ++m) {
                const int row = u.pm * 256 + ai * 128 + wr * 64 + m * 16 + fr;
#pragma unroll
                for (int bj = 0; bj < 2; ++bj) {
                    const size_t off = (size_t)row * DM + u.pn * 256 + bj * 128 + wc * 32 + 8 * fq;
                    const f32x4 x0 = *(const f32x4*)(x + off), x1 = *(const f32x4*)(x + off + 4);
                    *(f32x4*)(out + off) = x0 * DN_ALPHA + acc[ai][bj][m][0];
                    *(f32x4*)(out + off + 4) = x1 * DN_ALPHA + acc[ai][bj][m][1];
                }
            }
    }
};

template <bool PERMROWS>
__device__ __forceinline__ void p0_transpose_item(const float* W, int K, int N, bf16* WT, LAS float* scr, int item, int lane) {
    const int nblk = N / 32, kb = item / nblk, nb = item % nblk, k0 = 64 * kb, n0 = 32 * nb;
#pragma unroll 8
    for (int i = 0; i < 32; ++i) { const int kk = 2 * i + (lane >> 5); scr[kk * 33 + (lane & 31)] = W[(size_t)(k0 + kk) * N + n0 + (lane & 31)]; }
    asm volatile("s_waitcnt lgkmcnt(0)" ::: "memory");
    const int c = lane & 7;
#pragma unroll
    for (int j = 0; j < 4; ++j) { const int n = (lane >> 3) + 8 * j; const LAS float* s = scr + (8 * c) * 33 + n;
        u32x4 o; o.x = pk2(s[0 * 33], s[1 * 33]); o.y = pk2(s[2 * 33], s[3 * 33]); o.z = pk2(s[4 * 33], s[5 * 33]); o.w = pk2(s[6 * 33], s[7 * 33]);
        int col = n0 + n;
        if (PERMROWS) { const int cc = col & 255; col = (col & ~255) + ((cc >> 5) & 1) * 128 + (cc >> 6) * 32 + (cc & 31); }
        *(u32x4*)(WT + (size_t)col * K + k0 + 8 * c) = o; }
    asm volatile("s_waitcnt lgkmcnt(0)" ::: "memory");
}
__device__ __forceinline__ void cvt_rows(const float* src, bf16* dst, size_t nchunk8, size_t gtid, size_t nthr) {
    for (size_t i = gtid; i < nchunk8; i += nthr) {
        const f32x4 a = *(const f32x4*)(src + i * 8), b = *(const f32x4*)(src + i * 8 + 4);
        u32x4 o; o.x = pk2(a[0], a[1]); o.y = pk2(a[2], a[3]); o.z = pk2(b[0], b[1]); o.w = pk2(b[2], b[3]);
        *(u32x4*)(dst + i * 8) = o;
    }
}
__device__ __forceinline__ void p0_prologue(const Args& a, LAS unsigned char* lds) {
    const int tid = threadIdx.x, lane = tid & 63, wave = tid >> 6, G = gridDim.x;
    LAS float* scr = (LAS float*)(lds + wave * 16384);
    const int gw = blockIdx.x * 8 + wave, NGW = G * 8;
    bf16* WT_IN = (bf16*)(a.ws + WS_WIN); bf16* WT_OUT = (bf16*)(a.ws + WS_WOUT); bf16* WT_MEM = (bf16*)(a.ws + WS_WMEM);
    constexpr int I_IN = (DM / 64) * (DIN / 32), I_OUT = (DMIX / 64) * (DM / 32), I_MEM = (DM / 64) * (WMEM / 32);
    for (int it = gw; it < I_IN + I_OUT + I_MEM; it += NGW) {
        int r = it;
        if (r < I_IN) { p0_transpose_item<true>(a.w_in, DM, DIN, WT_IN, scr, r, lane); continue; } r -= I_IN;
        if (r < I_OUT) { p0_transpose_item<false>(a.w_out, DMIX, DM, WT_OUT, scr, r, lane); continue; } r -= I_OUT;
        p0_transpose_item<false>(a.w_mem, DM, WMEM, WT_MEM, scr, r, lane);
    }
    const size_t gtid = (size_t)blockIdx.x * 512 + tid, nthr = (size_t)G * 512;
    cvt_rows(a.x, (bf16*)(a.ws + WS_XB), (size_t)NTOK * DM / 8, gtid, nthr);
    cvt_rows(a.mem, (bf16*)(a.ws + WS_MEMB), (size_t)NMEM * DM / 8, gtid, nthr);
    float* cosT = (float*)(a.ws + WS_COS); float* sinT = (float*)(a.ws + WS_SIN);
    for (size_t i = gtid; i < (size_t)SEQ * 32; i += nthr) {
        const int pos = (int)(i >> 5), fi = (int)(i & 31);
        const float inv = (float)exp2(-(double)(2 * fi) * (13.287712379549449 / 64.0));
        const float ang = (float)pos * inv;
        const double ad = (double)ang, kk = __builtin_rint(ad * 0.15915494309189535);
        double r = __builtin_fma(-kk, 6.283185307179586, ad); r = __builtin_fma(-kk, 2.4492935982947064e-16, r);
        const float rf = (float)r;
        cosT[i] = __cosf(rf); sinT[i] = __sinf(rf);
    }
}

constexpr int KT_STRIDE = 8 * 1040;
constexpr int K_BYTES = 4 * KT_STRIDE, V_BYTES = 4 * 8192, HALF_BYTES = K_BYTES + V_BYTES;
constexpr int WSF_OFF = 2 * HALF_BYTES, OST_OFF = WSF_OFF + 8 * 256, ATT_LDS = OST_OFF + 8 * 2048;
constexpr int LDS_BYTES = ATT_LDS > 131072 ? ATT_LDS : 131072;
constexpr int N_SUB = 6144;

struct Sub {
    const bf16 *q, *k, *v; bf16* o; float* lse;
    int qstride, kstride, ostride, lstride, maxd, t0, has_sink; float minit, sink2;
};
__device__ __forceinline__ void decode_sub(const Args& a, int s, Sub& u) {
    const bf16* H = (const bf16*)(a.ws + WS_H);
    u.lse = nullptr; u.lstride = 0; u.has_sink = 0; u.minit = -1e30f; u.sink2 = 0.f;
    if (s < 1024) {
        const int head = s & 3, blk = (s >> 2) & 15, bt = s >> 6; const long tok0 = (long)bt * SEQ + 128 * blk;
        u.q = H + tok0 * DIN + 1536 + head * 64; u.qstride = DIN;
        u.k = (const bf16*)(a.ws + WS_MKV) + (long)bt * MEML * WMEM + head * 64; u.v = u.k + 256; u.kstride = WMEM;
        u.o = (bf16*)(a.ws + WS_OC) + tok0 * 256 + head * 64; u.ostride = 256; u.maxd = -1; u.t0 = 0;
    } else if (s < 3072) {
        const int idx = s - 1024, head = idx & 7, blk = (idx >> 3) & 15, bt = idx >> 7; const long tok0 = (long)bt * SEQ + 128 * blk;
        u.q = H + tok0 * DIN + head * 64; u.qstride = DIN;
        u.k = H + (tok0 - 128) * DIN + 512 + (head >> 2) * 64; u.v = u.k + 128; u.kstride = DIN;
        u.o = (bf16*)(a.ws + WS_OA) + tok0 * 512 + head * 64; u.ostride = 512; u.maxd = 127; u.t0 = blk == 0 ? 2 : 0;
        u.has_sink = 1; u.sink2 = a.sinks[head] * LOG2E; u.minit = u.sink2;
    } else {
        const int p = (s - 3072) >> 10, idx = (s - 3072) & 1023, sh = 2 * p, dil = 1 << sh, nblk = 16 >> sh;
        const int head = idx & 3, rest = idx >> 2, blk = rest & (nblk - 1), stream = rest >> (4 - sh), bt = stream >> sh, r = stream & (dil - 1);
        const long tok0 = (long)bt * SEQ + (long)128 * blk * dil + r;
        u.q = H + tok0 * DIN + 768 + head * 64; u.qstride = dil * DIN;
        u.k = H + (tok0 - 128 * dil) * DIN + 1024 + head * 64; u.v = u.k + 256; u.kstride = dil * DIN;
        u.o = (bf16*)(a.ws + WS_OB) + (size_t)p * NTOK * 256 + tok0 * 256 + head * 64; u.ostride = dil * 256;
        u.lse = (float*)(a.ws + WS_LSE) + (size_t)p * NTOK * 4 + tok0 * 4 + head; u.lstride = dil * 4;
        u.maxd = 128; u.t0 = blk == 0 ? 2 : 0;
    }
}
__device__ __forceinline__ int crow(int r, int hi) { return (r & 3) + 8 * (r >> 2) + 4 * hi; }
__device__ __forceinline__ s16x4 vtr(const LAS unsigned char* p) {
    typedef short v4i16_t __attribute__((ext_vector_type(4)));
    return __builtin_bit_cast(s16x4, __builtin_amdgcn_ds_read_tr16_b64_v4i16((LAS v4i16_t*)p)); }
typedef float f32x2_t __attribute__((ext_vector_type(2))); typedef __bf16 bf16x2_t __attribute__((ext_vector_type(2)));
__device__ __forceinline__ unsigned cvtpk(float lo, float hi) { f32x2_t v = {lo, hi}; bf16x2_t b = __builtin_convertvector(v, bf16x2_t); return __builtin_bit_cast(unsigned, b); }

__device__ __forceinline__ void attn_phase(const Args& a, LAS unsigned char* lds) {
    const int tid = threadIdx.x, lane = tid & 63, wave = __builtin_amdgcn_readfirstlane(tid >> 6), hb = wave >> 2, w = wave & 3, tq = tid & 255;
    const int r32 = lane & 31, hi = lane >> 5;
    LAS unsigned char* kbase = lds + hb * HALF_BYTES; LAS unsigned char* vbase = kbase + K_BYTES;
    LAS float* wsf = (LAS float*)(lds + WSF_OFF + wave * 256);
    LAS bf16* ost = (LAS bf16*)(lds + OST_OFF + wave * 2048);
    const int G = gridDim.x;
    for (int U = blockIdx.x; U < N_SUB / 2; U += G) {
        Sub u; decode_sub(a, 2 * U + hb, u);
        const int qrow = 32 * w + r32;
        bf16x8 qr[4];
        { const bf16* qp = u.q + (long)qrow * u.qstride + 8 * hi;
#pragma unroll
          for (int d0 = 0; d0 < 4; ++d0) qr[d0] = *(const bf16x8*)(qp + 16 * d0); }
        { const int c = tq & 7, key0 = tq >> 3;
          u32x4 kv[8], vv[8];
#pragma unroll
          for (int i = 0; i < 8; ++i) if ((i >> 1) >= u.t0) { const long off = (long)(i * 32 + key0) * u.kstride + c * 8;
              kv[i] = *(const u32x4*)(u.k + off); vv[i] = *(const u32x4*)(u.v + off); }
#pragma unroll
          for (int i = 0; i < 8; ++i) if ((i >> 1) >= u.t0) { const int key = i * 32 + key0, tile = i >> 1, k64 = key & 63;
              *(LAS u32x4*)(kbase + tile * KT_STRIDE + c * 1040 + k64 * 16) = kv[i];
              *(LAS u32x4*)(vbase + tile * 8192 + (c >> 2) * 4096 + (k64 >> 4) * 1024 + (k64 & 15) * 64 + (c & 3) * 16) = vv[i]; }
        }
        __syncthreads();
        int tlo = 0, thi = 3;
        if (u.maxd >= 0) { tlo = (32 * w + 128 - u.maxd) >> 6; thi = (32 * w + 159) >> 6; if (tlo < u.t0) tlo = u.t0; }
        float m = u.minit, l = 0.f;
        f32x16 o0, o1;
#pragma unroll
        for (int r = 0; r < 16; ++r) { o0[r] = 0.f; o1[r] = 0.f; }
        for (int t = tlo; t <= thi; ++t) {
            const LAS unsigned char* kt = kbase + t * KT_STRIDE + hi * 1040 + r32 * 16;
            f32x16 p0, p1;
#pragma unroll
            for (int r = 0; r < 16; ++r) { p0[r] = 0.f; p1[r] = 0.f; }
#pragma unroll
            for (int d0 = 0; d0 < 4; ++d0) {
                const bf16x8 b0 = *(const LAS bf16x8*)(kt + d0 * 2080), b1 = *(const LAS bf16x8*)(kt + d0 * 2080 + 512);
                p0 = __builtin_amdgcn_mfma_f32_32x32x16_bf16(b0, qr[d0], p0, 0, 0, 0);
                p1 = __builtin_amdgcn_mfma_f32_32x32x16_bf16(b1, qr[d0], p1, 0, 0, 0);
            }
            if (u.maxd >= 0) {
                const int base = qrow + 128 - 64 * t;
#pragma unroll
                for (int r = 0; r < 16; ++r) { const int d0_ = base - crow(r, hi), d1_ = d0_ - 32;
                    if (d0_ < 0 || d0_ > u.maxd) p0[r] = -INFINITY;
                    if (d1_ < 0 || d1_ > u.maxd) p1[r] = -INFINITY; }
            }
            float rm = fmaxf(p0[0], p1[0]);
#pragma unroll
            for (int r = 1; r < 16; ++r) rm = fmaxf(rm, fmaxf(p0[r], p1[r]));
            rm = fmaxf(rm, __shfl_xor(rm, 32));
            const float mn = fmaxf(m, rm), al = __builtin_amdgcn_exp2f(m - mn); m = mn;
            float ps = 0.f;
#pragma unroll
            for (int r = 0; r < 16; ++r) { p0[r] = __builtin_amdgcn_exp2f(p0[r] - mn); p1[r] = __builtin_amdgcn_exp2f(p1[r] - mn); ps += p0[r] + p1[r]; }
            l = l * al + ps;
            if (hi == 0) wsf[r32] = al;
#pragma unroll
            for (int r = 0; r < 16; ++r) { const float f = wsf[crow(r, hi)]; o0[r] *= f; o1[r] *= f; }
            u32x4 pw[4];
#pragma unroll
            for (int j = 0; j < 4; ++j) { pw[0][j] = cvtpk(p0[2 * j], p0[2 * j + 1]); pw[1][j] = cvtpk(p0[8 + 2 * j], p0[9 + 2 * j]);
                                          pw[2][j] = cvtpk(p1[2 * j], p1[2 * j + 1]); pw[3][j] = cvtpk(p1[8 + 2 * j], p1[9 + 2 * j]); }
            const LAS unsigned char* vt = vbase + t * 8192 + ((lane >> 4) & 1) * 32 + (lane & 3) * 8 + (4 * hi + ((lane & 15) >> 2)) * 64;
#pragma unroll
            for (int ks = 0; ks < 4; ++ks) {
                const bf16x8 pa = __builtin_bit_cast(bf16x8, pw[ks]);
                { const s16x4 lo = vtr(vt + ks * 1024), hh = vtr(vt + ks * 1024 + 512);
                  const bf16x8 vf = {lo[0], lo[1], lo[2], lo[3], hh[0], hh[1], hh[2], hh[3]};
                  o0 = __builtin_amdgcn_mfma_f32_32x32x16_bf16(pa, vf, o0, 0, 0, 0); }
                { const s16x4 lo = vtr(vt + 4096 + ks * 1024), hh = vtr(vt + 4096 + ks * 1024 + 512);
                  const bf16x8 vf = {lo[0], lo[1], lo[2], lo[3], hh[0], hh[1], hh[2], hh[3]};
                  o1 = __builtin_amdgcn_mfma_f32_32x32x16_bf16(pa, vf, o1, 0, 0, 0); }
            }
        }
        l += __shfl_xor(l, 32);
        if (u.has_sink) l += __builtin_amdgcn_exp2f(u.sink2 - m);
        const float inv = 1.f / l;
        if (hi == 0) { wsf[r32] = inv; if (u.lse) u.lse[(long)qrow * u.lstride] = m + __builtin_amdgcn_logf(l); }
        float fr_[16];
#pragma unroll
        for (int r = 0; r < 16; ++r) fr_[r] = wsf[crow(r, hi)];
#pragma unroll
        for (int d0 = 0; d0 < 2; ++d0) {
#pragma unroll
            for (int r = 0; r < 16; ++r) { const float val = (d0 == 0 ? o0[r] : o1[r]) * fr_[r]; ost[crow(r, hi) * 32 + r32] = (bf16)f2bf(val); }
#pragma unroll
            for (int i = 0; i < 2; ++i) { const int id = lane + 64 * i, row = id >> 2, ch = id & 3;
                const u32x4 v = *(const LAS u32x4*)(ost + row * 32 + ch * 8);
                *(u32x4*)(u.o + (long)(32 * w + row) * u.ostride + d0 * 32 + ch * 8) = v; }
        }
        __syncthreads();
    }
}

__device__ __forceinline__ void unpack16(const u32x4 a, const u32x4 b, float (&f)[16]) {
#pragma unroll
    for (int j = 0; j < 4; ++j) { f[2 * j] = bf_lo(a[j]); f[2 * j + 1] = bf_hi(a[j]); f[8 + 2 * j] = bf_lo(b[j]); f[9 + 2 * j] = bf_hi(b[j]); }
}
__device__ __forceinline__ void combine_phase(const Args& a) {
    const int tid = threadIdx.x, lane = tid & 63, wave = tid >> 6;
    const bf16* H = (const bf16*)(a.ws + WS_H); const bf16* OA = (const bf16*)(a.ws + WS_OA); const bf16* OB = (const bf16*)(a.ws + WS_OB);
    const bf16* OC = (const bf16*)(a.ws + WS_OC); const float* LSE = (const float*)(a.ws + WS_LSE); bf16* Y = (bf16*)(a.ws + WS_Y);
    const int gw = blockIdx.x * 8 + wave, NGW = gridDim.x * 8;
    float g[16];
#pragma unroll
    for (int j = 0; j < 4; ++j) { const f32x4 t = *(const f32x4*)(a.g_branch + 16 * lane + 4 * j); g[4 * j] = t[0]; g[4 * j + 1] = t[1]; g[4 * j + 2] = t[2]; g[4 * j + 3] = t[3]; }
    for (int tok = gw; tok < NTOK; tok += NGW) {
        float v[16];
        if (lane < 32) { const bf16* p = OA + (size_t)tok * 512 + 16 * lane; unpack16(*(const u32x4*)p, *(const u32x4*)(p + 8), v); }
        else if (lane < 48) {
            const int cb = 16 * (lane - 32), head = cb >> 6;
            float ls[3], mx;
#pragma unroll
            for (int p = 0; p < 3; ++p) ls[p] = LSE[(size_t)p * NTOK * 4 + (size_t)tok * 4 + head];
            mx = fmaxf(ls[0], fmaxf(ls[1], ls[2]));
            float wgt[3], ws = 0.f;
#pragma unroll
            for (int p = 0; p < 3; ++p) { wgt[p] = __builtin_amdgcn_exp2f(ls[p] - mx); ws += wgt[p]; }
            const float iw = 1.f / ws;
#pragma unroll
            for (int j = 0; j < 16; ++j) v[j] = 0.f;
#pragma unroll
            for (int p = 0; p < 3; ++p) { float t[16]; const bf16* q = OB + (size_t)p * NTOK * 256 + (size_t)tok * 256 + cb; unpack16(*(const u32x4*)q, *(const u32x4*)(q + 8), t);
                const float wp = wgt[p] * iw;
#pragma unroll
                for (int j = 0; j < 16; ++j) v[j] += wp * t[j]; }
        } else { const bf16* p = OC + (size_t)tok * 256 + 16 * (lane - 48); unpack16(*(const u32x4*)p, *(const u32x4*)(p + 8), v); }
        float ss = 0.f;
#pragma unroll
        for (int j = 0; j < 16; ++j) ss += v[j] * v[j];
        ss += __shfl_xor(ss, 1); ss += __shfl_xor(ss, 2); ss += __shfl_xor(ss, 4); ss += __shfl_xor(ss, 8);
        const float so = __shfl_xor(ss, 16);
        float rstd;
        if (lane < 32) rstd = 1.0f / sqrtf((ss + so) * (1.f / 512.f) + RMS_EPS); else rstd = 1.0f / sqrtf(ss * (1.f / 256.f) + RMS_EPS);
        float z[16]; { const bf16* zp = H + (size_t)tok * DIN + 1792 + 16 * lane; unpack16(*(const u32x4*)zp, *(const u32x4*)(zp + 8), z); }
        u32x4 o0, o1;
#pragma unroll
        for (int j = 0; j < 4; ++j) {
            float y0[4];
#pragma unroll
            for (int e = 0; e < 4; ++e) { const int k = 4 * j + e; const float zz = z[k]; const float si = zz / (1.f + __expf(-zz)); y0[e] = v[k] * rstd * g[k] * si; }
            if (j < 2) { o0[2 * j] = pk2(y0[0], y0[1]); o0[2 * j + 1] = pk2(y0[2], y0[3]); } else { o1[2 * (j - 2)] = pk2(y0[0], y0[1]); o1[2 * (j - 2) + 1] = pk2(y0[2], y0[3]); }
        }
        bf16* yp = Y + (size_t)tok * DMIX + 16 * lane; *(u32x4*)yp = o0; *(u32x4*)(yp + 8) = o1;
    }
}
__device__ __forceinline__ float wave_sum(float v) {
#pragma unroll
    for (int o = 1; o < 64; o <<= 1) v += __shfl_xor(v, o);
    return v;
}
__device__ __forceinline__ void ln_phase(const Args& a) {
    const int tid = threadIdx.x, lane = tid & 63, wave = tid >> 6;
    const int gw = blockIdx.x * 8 + wave, NGW = gridDim.x * 8;
    f32x4 gn[4], bs[4];
#pragma unroll
    for (int j = 0; j < 4; ++j) { gn[j] = *(const f32x4*)(a.ln_g + 4 * lane + 256 * j); bs[j] = *(const f32x4*)(a.ln_b + 4 * lane + 256 * j); }
    for (int row = gw; row < NTOK; row += NGW) {
        f32x4* p = (f32x4*)(a.out + (size_t)row * DM) + lane;
        f32x4 v[4]; float s = 0.f;
#pragma unroll
        for (int j = 0; j < 4; ++j) { v[j] = p[64 * j]; s += (v[j][0] + v[j][1]) + (v[j][2] + v[j][3]); }
        const float mean = wave_sum(s) * (1.f / DM); float s2 = 0.f;
#pragma unroll
        for (int j = 0; j < 4; ++j) { v[j] = v[j] - mean; s2 += (v[j][0] * v[j][0] + v[j][1] * v[j][1]) + (v[j][2] * v[j][2] + v[j][3] * v[j][3]); }
        const float rstd = 1.f / sqrtf(wave_sum(s2) * (1.f / DM) + LN_EPS);
#pragma unroll
        for (int j = 0; j < 4; ++j) p[64 * j] = v[j] * rstd * gn[j] + bs[j];
    }
}

__global__ void __launch_bounds__(512, 2) fwd_kernel(Args a) {
    extern __shared__ __attribute__((aligned(16))) unsigned char lds_raw[];
    LAS unsigned char* lds = (LAS unsigned char*)lds_raw;
    cg::grid_group grid = cg::this_grid();
    const int lo = a.ph_lo, hi = a.ph_hi, G = gridDim.x;
#define IN(k) (lo <= (k) && (k) < hi)
#define SEAM(k) do { if (IN(k) && IN((k) + 1)) grid.sync(); } while (0)
    if (IN(0)) p0_prologue(a, lds);
    SEAM(0);
    if (IN(1)) {
        { pg8::Gemm g{(const bf16*)(a.ws + WS_XB), (const bf16*)(a.ws + WS_WIN), NTOK, DIN, DM}; pg8::StaticOrder S; S.init(NTOK, DIN, G, (int)blockIdx.x);
          EpiIn E{(bf16*)(a.ws + WS_H), a.b_in, (const float*)(a.ws + WS_COS), (const float*)(a.ws + WS_SIN)};
          pg8::gemm_phase<EpiIn, pg8::StaticOrder, true, true>(lds, g, S, E); }
        { pg8::Gemm g{(const bf16*)(a.ws + WS_MEMB), (const bf16*)(a.ws + WS_WMEM), NMEM, WMEM, DM}; pg8::StaticOrder S; S.init(NMEM, WMEM, G, (int)((blockIdx.x + G - (G >> 1)) % G));
          pg8::EpiBf16<0> E{(bf16*)(a.ws + WS_MKV), WMEM, nullptr, 0, 0, 1.f};
          pg8::gemm_phase<pg8::EpiBf16<0>, pg8::StaticOrder, true, true>(lds, g, S, E); }
    }
    SEAM(1);
    if (IN(2)) attn_phase(a, lds);
    SEAM(2);
    if (IN(3)) combine_phase(a);
    SEAM(3);
    if (IN(4)) {
        pg8::Gemm g{(const bf16*)(a.ws + WS_Y), (const bf16*)(a.ws + WS_WOUT), NTOK, DM, DMIX}; pg8::StaticOrder S; S.init(NTOK, DM, G, (int)blockIdx.x);
        EpiOut E{a.x, a.out};
        pg8::gemm_phase<EpiOut, pg8::StaticOrder, true, true>(lds, g, S, E);
    }
    SEAM(4);
    if (IN(5)) ln_phase(a);
#undef IN
#undef SEAM
}

extern "C" void kernel_launch(void* const* d_in, const int* in_sizes, int n_in, void* d_out, int out_size, void* d_ws, size_t ws_size, hipStream_t stream) {
    static int grid = 0;
    if (grid == 0) {
        if (n_in != 10 || in_sizes[0] != NTOK * DM || out_size != NTOK * DM || ws_size < WS_END) { fprintf(stderr, "kernel_launch: unexpected shapes (n_in %d, ws %zu)\n", n_in, ws_size); grid = -1; return; }
        int dev = 0, cus = 0, per_cu = 0;
        (void)hipGetDevice(&dev); (void)hipDeviceGetAttribute(&cus, hipDeviceAttributeMultiprocessorCount, dev);
        if (hipFuncSetAttribute((const void*)fwd_kernel, hipFuncAttributeMaxDynamicSharedMemorySize, LDS_BYTES) != hipSuccess) { fprintf(stderr, "kernel_launch: hipFuncSetAttribute failed\n"); grid = -1; return; }
        if (hipOccupancyMaxActiveBlocksPerMultiprocessor(&per_cu, (const void*)fwd_kernel, 512, LDS_BYTES) != hipSuccess || per_cu < 1) { fprintf(stderr, "kernel_launch: occupancy query says %d\n", per_cu); per_cu = 1; }
        (void)hipGetLastError();
        grid = cus;
    }
    if (grid < 0) return;
    Args a{};
    a.x = (const float*)d_in[0]; a.mem = (const float*)d_in[1]; a.w_in = (const float*)d_in[2]; a.b_in = (const float*)d_in[3]; a.w_mem = (const float*)d_in[4];
    a.sinks = (const float*)d_in[5]; a.g_branch = (const float*)d_in[6]; a.w_out = (const float*)d_in[7]; a.ln_g = (const float*)d_in[8]; a.ln_b = (const float*)d_in[9];
    a.out = (float*)d_out; a.ws = (unsigned char*)d_ws;
    if (N_LAUNCHES == 1) {
        a.ph_lo = 0; a.ph_hi = NPHASE;
        void* args[] = {&a};
        hipError_t e = hipLaunchCooperativeKernel((const void*)fwd_kernel, dim3(grid), dim3(512), args, LDS_BYTES, stream);
        if (e != hipSuccess) fprintf(stderr, "kernel_launch: cooperative launch failed: %s (grid %d)\n", hipGetErrorString(e), grid);
    } else {
        for (int k = 0; k < NPHASE; ++k) { a.ph_lo = k; a.ph_hi = k + 1; hipLaunchKernelGGL(fwd_kernel, dim3(grid), dim3(512), LDS_BYTES, stream, a); }
    }
}
```
